# Optimizing an MI355X kernel written in HIP

```python
import math
import jax, jax.numpy as jnp
from jax import lax
import numpy as np

D_MODEL = 1024
BATCH = 16
SEQ = 2048
DEPTH = 2

DEEPNORM_ALPHA = (2 * DEPTH) ** 0.25
DEEPNORM_BETA = (8 * DEPTH) ** -0.25
LN_EPS = 1e-5
RMS_EPS = 1e-6
ADA_INIT = 0.1

CONV_CH = D_MODEL // 2
CONV_WIDTH = 31

GLA_HEADS = 4
GLA_V_WIDTH = D_MODEL // 2
GLA_K_WIDTH = GLA_V_WIDTH // 2
GLA_HEAD_K = GLA_K_WIDTH // GLA_HEADS
GLA_HEAD_V = GLA_V_WIDTH // GLA_HEADS
GLA_GATE_RANK = 16
GLA_GATE_TAU = 16.0
GLA_CHUNK = 64

AB_SPLITS = [2 * CONV_CH,
             2 * CONV_CH + GLA_K_WIDTH,
             2 * CONV_CH + 2 * GLA_K_WIDTH,
             2 * CONV_CH + 2 * GLA_K_WIDTH + GLA_V_WIDTH,
             2 * CONV_CH + 2 * GLA_K_WIDTH + 2 * GLA_V_WIDTH]
AB_IN = AB_SPLITS[-1] + GLA_GATE_RANK
AB_OUT = CONV_CH + GLA_V_WIDTH

MLA_HEADS = 8
MLA_NOPE = 128
MLA_ROPE = 64
MLA_V = 128
MLA_Q_LORA = 384
MLA_KV_LORA = 256
MLA_IN = MLA_Q_LORA + MLA_KV_LORA + MLA_ROPE
MLA_SCALE = (MLA_NOPE + MLA_ROPE) ** -0.5
ROPE_THETA = 10000.0
Q_BLOCK = 128

MOE_GROUPS = 4
MOE_EXPERTS_PER_GROUP = 8
MOE_EXPERTS = MOE_GROUPS * MOE_EXPERTS_PER_GROUP
MOE_TOPK = 2
MOE_FF = 256

kernel_name = "hybrid_conv_gla_mla_hmoe_deepnorm"


def layer_norm(x, g, b):
    xf = x.astype(jnp.float32)
    mu = jnp.mean(xf, axis=-1, keepdims=True)
    var = jnp.mean(jnp.square(xf - mu), axis=-1, keepdims=True)
    return ((xf - mu) * lax.rsqrt(var + LN_EPS) * g + b).astype(x.dtype)


def rms_norm(x, g):
    xf = x.astype(jnp.float32)
    return (xf * lax.rsqrt(jnp.mean(jnp.square(xf), axis=-1, keepdims=True) + RMS_EPS) * g).astype(x.dtype)


def apply_rope(x, cos, sin):
    xf = x.astype(jnp.float32)
    x1, x2 = jnp.split(xf, 2, axis=-1)
    return jnp.concatenate([x1 * cos - x2 * sin, x1 * sin + x2 * cos], axis=-1).astype(x.dtype)


def conformer_conv(u, conv_w, conv_b, ln_g, ln_b):
    a, gate = jnp.split(u, 2, axis=-1)
    h = a * jax.nn.sigmoid(gate)
    h = lax.conv_general_dilated(
        h, conv_w[:, None, :], window_strides=(1,), padding=[(CONV_WIDTH - 1, 0)],
        dimension_numbers=('NWC', 'WIO', 'NWC'), feature_group_count=CONV_CH) + conv_b
    return jax.nn.silu(layer_norm(h, ln_g, ln_b))


def gla_chunked(q, k, v, glog):
    B, S, H, DK = q.shape
    DV = v.shape[-1]
    C = GLA_CHUNK
    NC = S // C

    def chunks(t):
        return t.astype(jnp.float32).reshape(B, NC, C, H, t.shape[-1]).transpose(1, 0, 3, 2, 4)

    qc = chunks(q) * (DK ** -0.5)
    kc = chunks(k)
    vc = chunks(v)
    bc = jnp.cumsum(chunks(glog), axis=3)
    causal = jnp.tril(jnp.ones((C, C), dtype=bool))

    def step(state, inp):
        qi, ki, vi, bi = inp
        o_inter = jnp.einsum('bhik,bhkv->bhiv', qi * jnp.exp(bi), state)
        diff = bi[:, :, :, None, :] - bi[:, :, None, :, :]
        decay = jnp.exp(jnp.where(causal[:, :, None], diff, -jnp.inf))
        att = jnp.einsum('bhijk,bhjk->bhij', qi[:, :, :, None, :] * decay, ki)
        o = o_inter + jnp.einsum('bhij,bhjv->bhiv', att, vi)
        b_last = bi[:, :, -1, :]
        k_dec = ki * jnp.exp(b_last[:, :, None, :] - bi)
        state = jnp.exp(b_last)[..., None] * state + jnp.einsum('bhjk,bhjv->bhkv', k_dec, vi)
        return state, o

    state0 = jnp.zeros((B, H, DK, DV), jnp.float32)
    _, o = lax.scan(step, state0, (qc, kc, vc, bc))
    return o.transpose(1, 0, 3, 2, 4).reshape(B, S, H, DV)


def conv_gla_mixer(h, w_in, conv_w, conv_b, conv_ln_g, conv_ln_b, gate_w, gate_b, norm_g, w_out):
    B, S, _ = h.shape
    u = h @ w_in
    u_conv, q, k, v, r, g_low = jnp.split(u, AB_SPLITS, axis=-1)
    y_a = conformer_conv(u_conv, conv_w, conv_b, conv_ln_g, conv_ln_b)
    glog = jax.nn.log_sigmoid((g_low @ gate_w + gate_b).astype(jnp.float32)) / GLA_GATE_TAU
    o = gla_chunked(q.reshape(B, S, GLA_HEADS, GLA_HEAD_K),
                    k.reshape(B, S, GLA_HEADS, GLA_HEAD_K),
                    v.reshape(B, S, GLA_HEADS, GLA_HEAD_V),
                    glog.reshape(B, S, GLA_HEADS, GLA_HEAD_K))
    o = rms_norm(o, norm_g.reshape(GLA_HEADS, GLA_HEAD_V)).reshape(B, S, GLA_V_WIDTH)
    y_b = (o * jax.nn.silu(r.astype(jnp.float32))).astype(h.dtype)
    return jnp.concatenate([y_a.astype(h.dtype), y_b], axis=-1) @ w_out


def mla_mixer(h, cos, sin, w_in, q_norm_g, kv_norm_g, w_uq, w_ukv, w_out):
    B, S, _ = h.shape
    u = h @ w_in
    cq, ckv, k_rope = jnp.split(u, [MLA_Q_LORA, MLA_Q_LORA + MLA_KV_LORA], axis=-1)
    q = (rms_norm(cq, q_norm_g) @ w_uq).reshape(B, S, MLA_HEADS, MLA_NOPE + MLA_ROPE)
    kv = (rms_norm(ckv, kv_norm_g) @ w_ukv).reshape(B, S, MLA_HEADS, MLA_NOPE + MLA_V)
    q_nope, q_rope = jnp.split(q, [MLA_NOPE], axis=-1)
    k_nope, v = jnp.split(kv, [MLA_NOPE], axis=-1)
    q_rope = apply_rope(q_rope, cos[:, :, None, :], sin[:, :, None, :])
    k_rope = apply_rope(k_rope, cos, sin)
    nb = S // Q_BLOCK

    def blocks(t):
        return t.reshape(B, nb, Q_BLOCK, *t.shape[2:]).swapaxes(0, 1)

    key_idx = jnp.arange(S)

    def attend(args):
        qn, qr, blk = args
        s = (jnp.einsum('bqhd,bkhd->bhqk', qn, k_nope, preferred_element_type=jnp.float32)
             + jnp.einsum('bqhr,bkr->bhqk', qr, k_rope, preferred_element_type=jnp.float32)) * MLA_SCALE
        q_idx = blk * Q_BLOCK + jnp.arange(Q_BLOCK)
        s = jnp.where(key_idx[None, :] <= q_idx[:, None], s, -jnp.inf)
        p = jax.nn.softmax(s, axis=-1).astype(v.dtype)
        return jnp.einsum('bhqk,bkhv->bqhv', p, v)

    o = lax.map(attend, (blocks(q_nope), blocks(q_rope), jnp.arange(nb)))
    o = o.swapaxes(0, 1).reshape(B, S, MLA_HEADS * MLA_V)
    return o @ w_out


def hier_moe(h, w_group, b_group, w_router, b_router, w_gate, w_up, w_down):
    B, S, D = h.shape
    t = h.reshape(-1, D)
    T = t.shape[0]
    g_logits = jnp.dot(t, w_group, preferred_element_type=jnp.float32) + b_group
    g_prob = jax.nn.softmax(g_logits, axis=-1)
    g_idx = jnp.argmax(g_logits, axis=-1)
    g_w = jnp.take_along_axis(g_prob, g_idx[:, None], axis=-1)[:, 0]
    e_logits = (jnp.dot(t, w_router, preferred_element_type=jnp.float32) + b_router
                ).reshape(T, MOE_GROUPS, MOE_EXPERTS_PER_GROUP)
    e_sel = jnp.take_along_axis(e_logits, g_idx[:, None, None], axis=1)[:, 0]
    top_v, top_i = lax.top_k(e_sel, MOE_TOPK)
    top_w = jax.nn.softmax(top_v, axis=-1) * g_w[:, None]
    e_id = g_idx[:, None] * MOE_EXPERTS_PER_GROUP + top_i
    comb = jnp.sum(jax.nn.one_hot(e_id, MOE_EXPERTS, dtype=jnp.float32) * top_w[..., None], axis=1)
    y = jnp.zeros((T, D), jnp.float32)
    for e in range(MOE_EXPERTS):
        hid = jax.nn.silu(t @ w_gate[e]) * (t @ w_up[e])
        y = y + comb[:, e:e + 1] * jnp.dot(hid, w_down[e], preferred_element_type=jnp.float32)
    return y.astype(h.dtype).reshape(B, S, D)


def setup_inputs(seed: int = 0) -> dict:
    key = jax.random.key(seed)
    ks = iter(jax.random.split(key, 40))
    D = D_MODEL
    ne = (DEPTH + 1) // 2
    no = DEPTH // 2

    def nrm(shape, scale):
        return jax.random.normal(next(ks), shape, jnp.float32) * scale

    def gain(shape):
        return 1.0 + nrm(shape, 0.02)

    x = nrm((BATCH, SEQ, D), 1.0)
    c = nrm((BATCH, D), 1.0)
    offsets = jax.random.randint(next(ks), (BATCH, 1), 0, 4096)
    positions = (offsets + jnp.arange(SEQ)[None, :]).astype(jnp.int32)
    return {
        "x": x,
        "c": c,
        "positions": positions,
        "ada_w": nrm((DEPTH, D, 6 * D), ADA_INIT * D ** -0.5),
        "ada_b": nrm((DEPTH, 6 * D), 0.01),
        "ln_mix_g": gain((DEPTH, D)),
        "ln_mix_b": nrm((DEPTH, D), 0.02),
        "ln_ffn_g": gain((DEPTH, D)),
        "ln_ffn_b": nrm((DEPTH, D), 0.02),
        "ab_w_in": nrm((ne, D, AB_IN), D ** -0.5),
        "conv_w": nrm((ne, CONV_WIDTH, CONV_CH), CONV_WIDTH ** -0.5),
        "conv_b": nrm((ne, CONV_CH), 0.02),
        "conv_ln_g": gain((ne, CONV_CH)),
        "conv_ln_b": nrm((ne, CONV_CH), 0.02),
        "gla_gate_w": nrm((ne, GLA_GATE_RANK, GLA_K_WIDTH), GLA_GATE_RANK ** -0.5),
        "gla_gate_b": nrm((ne, GLA_K_WIDTH), 0.02),
        "gla_norm_g": gain((ne, GLA_V_WIDTH)),
        "ab_w_out": nrm((ne, AB_OUT, D), AB_OUT ** -0.5 * DEEPNORM_BETA),
        "mla_w_in": nrm((no, D, MLA_IN), D ** -0.5),
        "mla_q_norm_g": gain((no, MLA_Q_LORA)),
        "mla_kv_norm_g": gain((no, MLA_KV_LORA)),
        "mla_w_uq": nrm((no, MLA_Q_LORA, MLA_HEADS * (MLA_NOPE + MLA_ROPE)), MLA_Q_LORA ** -0.5),
        "mla_w_ukv": nrm((no, MLA_KV_LORA, MLA_HEADS * (MLA_NOPE + MLA_V)), MLA_KV_LORA ** -0.5),
        "mla_w_out": nrm((no, MLA_HEADS * MLA_V, D), (MLA_HEADS * MLA_V) ** -0.5 * DEEPNORM_BETA),
        "moe_w_group": nrm((DEPTH, D, MOE_GROUPS), D ** -0.5),
        "moe_b_group": nrm((DEPTH, MOE_GROUPS), 0.01),
        "moe_w_router": nrm((DEPTH, D, MOE_EXPERTS), D ** -0.5),
        "moe_b_router": nrm((DEPTH, MOE_EXPERTS), 0.01),
        "moe_w_gate": nrm((DEPTH, MOE_EXPERTS, D, MOE_FF), D ** -0.5),
        "moe_w_up": nrm((DEPTH, MOE_EXPERTS, D, MOE_FF), D ** -0.5),
        "moe_w_down": nrm((DEPTH, MOE_EXPERTS, MOE_FF, D), MOE_FF ** -0.5 * DEEPNORM_BETA),
    }


def reference(x, c, positions, ada_w, ada_b, ln_mix_g, ln_mix_b, ln_ffn_g, ln_ffn_b,
              ab_w_in, conv_w, conv_b, conv_ln_g, conv_ln_b, gla_gate_w, gla_gate_b,
              gla_norm_g, ab_w_out, mla_w_in, mla_q_norm_g, mla_kv_norm_g, mla_w_uq,
              mla_w_ukv, mla_w_out, moe_w_group, moe_b_group, moe_w_router, moe_b_router,
              moe_w_gate, moe_w_up, moe_w_down):
    inv_freq = 1.0 / (ROPE_THETA ** (jnp.arange(0, MLA_ROPE, 2, dtype=jnp.float32) / MLA_ROPE))
    ang = positions.astype(jnp.float32)[..., None] * inv_freq
    cos, sin = jnp.cos(ang), jnp.sin(ang)
    c_act = jax.nn.silu(c)

    for layer in range(DEPTH):
        mod = (c_act @ ada_w[layer] + ada_b[layer])[:, None, :]
        sh_m, sc_m, g_m, sh_f, sc_f, g_f = jnp.split(mod, 6, axis=-1)
        i = layer // 2

        h = x * (1.0 + sc_m) + sh_m
        if layer % 2 == 0:
            mix = conv_gla_mixer(h, ab_w_in[i], conv_w[i], conv_b[i], conv_ln_g[i], conv_ln_b[i],
                                 gla_gate_w[i], gla_gate_b[i], gla_norm_g[i], ab_w_out[i])
        else:
            mix = mla_mixer(h, cos, sin, mla_w_in[i], mla_q_norm_g[i], mla_kv_norm_g[i],
                            mla_w_uq[i], mla_w_ukv[i], mla_w_out[i])
        x = layer_norm(DEEPNORM_ALPHA * x + (1.0 + g_m) * mix, ln_mix_g[layer], ln_mix_b[layer])

        h = x * (1.0 + sc_f) + sh_f
        ffn = hier_moe(h, moe_w_group[layer], moe_b_group[layer], moe_w_router[layer],
                       moe_b_router[layer], moe_w_gate[layer], moe_w_up[layer], moe_w_down[layer])
        x = layer_norm(DEEPNORM_ALPHA * x + (1.0 + g_f) * ffn, ln_ffn_g[layer], ln_ffn_b[layer])
    return x
```

```cpp
#include <hip/hip_runtime.h>
#include <stdint.h>
#include <math.h>

typedef unsigned short bf16_t;

constexpr int T = 32768, D = 1024, NB = 16, SEQ = 2048;
constexpr float ALPHA = 1.41421356237309515f;
constexpr float LN_EPS = 1e-5f, RMS_EPS = 1e-6f;
constexpr int AB_IN = 2576;
constexpr float QSCALE = 0.07216878364870322f * 1.4426950408889634f;

constexpr size_t MiB = 1u << 20;
constexpr size_t WS_CTL = 0;
constexpr size_t WS_MOD = 1 * MiB;
constexpr size_t WS_CS = 2 * MiB;
constexpr size_t WS_RSTD = 10 * MiB;
constexpr size_t WS_TOPI = 11 * MiB;
constexpr size_t WS_TOPW = 12 * MiB;
constexpr size_t WS_GLOW = 13 * MiB;
constexpr size_t WS_HB = 136 * MiB;
constexpr size_t WS_A = 200 * MiB;
constexpr size_t WS_UB = WS_A;
constexpr size_t WS_GL = WS_A + 128 * MiB;
constexpr size_t WS_YAB = WS_A + 160 * MiB;
constexpr size_t WS_MIX = WS_A;
constexpr size_t WS_QF = WS_A;
constexpr size_t WS_U1 = WS_A;
constexpr size_t WS_KN = WS_A + 96 * MiB;
constexpr size_t WS_KR = WS_A + 160 * MiB;
constexpr size_t WS_VF = WS_A + 164 * MiB;
constexpr size_t WS_CQ = WS_A + 228 * MiB;
constexpr size_t WS_CKV = WS_A + 252 * MiB;
constexpr size_t WS_OB = WS_A + 228 * MiB;
constexpr size_t WS_END = WS_A + 292 * MiB;

__device__ __forceinline__ float bf2f(bf16_t v) { return __uint_as_float(((unsigned)v) << 16); }
__device__ __forceinline__ bf16_t f2bf(float f) { unsigned u = __float_as_uint(f); return (bf16_t)((u + 0x7fffu + ((u >> 16) & 1u)) >> 16); }
__device__ __forceinline__ float sigmoidf_(float x) { return 1.f / (1.f + expf(-x)); }
__device__ __forceinline__ float siluf_(float x) { return x / (1.f + expf(-x)); }

__global__ void k_adaln(const float* __restrict__ c, const float* __restrict__ ada_w, const float* __restrict__ ada_b, float* __restrict__ mod) {
    const int n = blockIdx.x * 256 + threadIdx.x;
    const int l = n / 6144, col = n % 6144;
    __shared__ float cs[16][256];
    float acc[16];
#pragma unroll
    for (int b = 0; b < 16; ++b) acc[b] = 0.f;
    for (int k0 = 0; k0 < 1024; k0 += 256) {
        __syncthreads();
        for (int b = 0; b < 16; ++b) cs[b][threadIdx.x] = siluf_(c[b * 1024 + k0 + threadIdx.x]);
        __syncthreads();
        for (int k = 0; k < 256; ++k) {
            const float w = ada_w[((size_t)l * 1024 + k0 + k) * 6144 + col];
#pragma unroll
            for (int b = 0; b < 16; ++b) acc[b] += cs[b][k] * w;
        }
    }
    const float bias = ada_b[l * 6144 + col];
#pragma unroll
    for (int b = 0; b < 16; ++b) mod[((size_t)l * 16 + b) * 6144 + col] = acc[b] + bias;
}

__constant__ double INV_FREQ[32] = {1.0, 0.7498942093324559, 0.5623413251903491, 0.4216965034285823, 0.31622776601683794, 0.23713737056616555, 0.1778279410038923, 0.1333521432163324,
    0.1, 0.07498942093324558, 0.056234132519034905, 0.042169650342858224, 0.03162277660168379, 0.02371373705661655, 0.01778279410038923, 0.01333521432163324,
    0.01, 0.007498942093324559, 0.005623413251903491, 0.004216965034285823, 0.00316227766016838, 0.0023713737056616554, 0.001778279410038923, 0.001333521432163324,
    0.001, 0.0007498942093324559, 0.0005623413251903491, 0.0004216965034285823, 0.00031622776601683794, 0.00023713737056616554, 0.0001778279410038923, 0.0001333521432163324};
__global__ void k_rope_tab(const int* __restrict__ pos, float* __restrict__ cs, float* __restrict__ sn) {
    const int i = blockIdx.x * 256 + threadIdx.x;
    const int t = i >> 5, f = i & 31;
    double rev = (double)pos[t] * INV_FREQ[f] * 0.15915494309189535;
    rev -= floor(rev);
    const float r = (float)rev;
    cs[i] = __builtin_amdgcn_cosf(r); sn[i] = __builtin_amdgcn_sinf(r);
}

__global__ void k_modulate(const float* __restrict__ x, const float* __restrict__ mod  , int sh_off, int sc_off, bf16_t* __restrict__ hb) {
    const size_t i = (size_t)blockIdx.x * 256 + threadIdx.x;
    const int row = (int)(i >> 10), col = (int)(i & 1023), b = row / SEQ;
    const float* m = mod + (size_t)b * 6144;
    hb[i] = f2bf(x[i] * (1.f + m[sc_off + col]) + m[sh_off + col]);
}

template <class F>
__global__ void __launch_bounds__(256) k_gemm(const bf16_t* __restrict__ A, int lda, const float* __restrict__ kscale, int K, F f) {
    __shared__ float as[16][256];
    const int j = blockIdx.x * 256 + threadIdx.x;
    const int row0 = blockIdx.y * 16;
    int c0 = 0, c1 = 0;
    const bool valid = j < f.nlog;
    if (valid) f.cols(j, c0, c1);
    float acc0[16], acc1[16];
#pragma unroll
    for (int r = 0; r < 16; ++r) { acc0[r] = 0.f; acc1[r] = 0.f; }
    for (int k0 = 0; k0 < K; k0 += 256) {
        __syncthreads();
        {
            const int kk = threadIdx.x;
            const float s = (kscale && k0 + kk < K) ? kscale[k0 + kk] : 1.f;
            for (int r = 0; r < 16; ++r) as[r][kk] = (k0 + kk < K) ? bf2f(A[(size_t)(row0 + r) * lda + k0 + kk]) * s : 0.f;
        }
        __syncthreads();
        const int kn = (K - k0) < 256 ? (K - k0) : 256;
        if (valid) {
            for (int k = 0; k < kn; ++k) {
                const float w0 = f.W[(size_t)(k0 + k) * f.ldw + c0];
                const float w1 = F::NC == 2 ? f.W[(size_t)(k0 + k) * f.ldw + c1] : 0.f;
#pragma unroll
                for (int r = 0; r < 16; ++r) { const float a = as[r][k]; acc0[r] += a * w0; if (F::NC == 2) acc1[r] += a * w1; }
            }
        }
    }
    if (valid) {
#pragma unroll
        for (int r = 0; r < 16; ++r) f.store(row0 + r, j, acc0[r], acc1[r]);
    }
}

struct FInProj {
    static constexpr int NC = 2;
    const float* W; int ldw; int nlog;
    bf16_t* UB; float* GLOW;
    __device__ void cols(int j, int& c0, int& c1) const {
        if (j < 512) { c0 = j; c1 = 512 + j; }
        else if (j < 2048) { c0 = j + 512; c1 = c0; }
        else { c0 = 2560 + (j - 2048); c1 = c0; }
    }
    __device__ void store(int row, int j, float v0, float v1) const {
        if (j < 512) UB[(size_t)row * 2048 + j] = f2bf(v0 * sigmoidf_(v1));
        else if (j < 2048) UB[(size_t)row * 2048 + j] = f2bf(v0);
        else GLOW[(size_t)row * 16 + (j - 2048)] = v0;
    }
};
struct FPlain {
    static constexpr int NC = 1;
    const float* W; int ldw; int nlog;
    float* O; int ldo; int pad;
    __device__ void cols(int j, int& c0, int& c1) const { c0 = j; c1 = j; }
    __device__ void store(int row, int j, float v0, float) const { O[(size_t)row * ldo + j] = v0; }
};
struct FQ {
    static constexpr int NC = 2;
    const float* W; int ldw; int nlog;
    bf16_t* QF; const float* rstd; const float* cs; const float* sn;
    __device__ void cols(int j, int& c0, int& c1) const {
        const int h = j / 160, d = j % 160;
        if (d < 128) { c0 = h * 192 + d; c1 = c0; }
        else { c0 = h * 192 + 128 + (d - 128); c1 = c0 + 32; }
    }
    __device__ void store(int row, int j, float v0, float v1) const {
        const int h = j / 160, d = j % 160;
        const float s = rstd[row] * QSCALE;
        if (d < 128) QF[(size_t)row * 1536 + h * 192 + d] = f2bf(v0 * s);
        else {
            const int i = d - 128; const float c = cs[(size_t)row * 32 + i], sn_ = sn[(size_t)row * 32 + i];
            const float x1 = v0 * s, x2 = v1 * s;
            QF[(size_t)row * 1536 + h * 192 + 128 + 2 * i] = f2bf(x1 * c - x2 * sn_);
            QF[(size_t)row * 1536 + h * 192 + 128 + 2 * i + 1] = f2bf(x1 * sn_ + x2 * c);
        }
    }
};
struct FKV {
    static constexpr int NC = 1;
    const float* W; int ldw; int nlog;
    bf16_t* KN; bf16_t* VF; const float* rstd;
    __device__ void cols(int j, int& c0, int& c1) const { c0 = j; c1 = j; }
    __device__ void store(int row, int j, float v0, float) const {
        const int h = j / 256, d = j % 256; const float v = v0 * rstd[row];
        if (d < 128) KN[(size_t)row * 1024 + h * 128 + d] = f2bf(v);
        else VF[(size_t)row * 1024 + h * 128 + (d - 128)] = f2bf(v);
    }
};

__global__ void k_gate(const float* __restrict__ glow, const float* __restrict__ gw, const float* __restrict__ gb, float* __restrict__ gl) {
    const int row = blockIdx.x, n = threadIdx.x;
    float a = gb[n];
#pragma unroll
    for (int i = 0; i < 16; ++i) a += glow[(size_t)row * 16 + i] * gw[i * 256 + n];
    const float ls = fminf(a, 0.f) - log1pf(expf(-fabsf(a)));
    gl[(size_t)row * 256 + n] = ls * (1.f / 16.f);
}

__global__ void __launch_bounds__(512) k_conv(const bf16_t* __restrict__ UB, const float* __restrict__ cw, const float* __restrict__ cb,
                                              const float* __restrict__ lg, const float* __restrict__ lb, bf16_t* __restrict__ YAB) {
    const int row = blockIdx.x, c = threadIdx.x, t = row % SEQ;
    float acc = cb[c];
    for (int j = 0; j < 31; ++j) { const int tt = t - 30 + j; if (tt >= 0) acc += cw[j * 512 + c] * bf2f(UB[(size_t)(row - 30 + j) * 2048 + c]); }
    __shared__ float red[8]; __shared__ float stat[2];
    float s = acc;
    for (int o = 32; o > 0; o >>= 1) s += __shfl_xor(s, o);
    if ((c & 63) == 0) red[c >> 6] = s;
    __syncthreads();
    if (c == 0) { float m = 0.f; for (int i = 0; i < 8; ++i) m += red[i]; stat[0] = m / 512.f; }
    __syncthreads();
    const float mean = stat[0], dv = acc - mean;
    float q = dv * dv;
    for (int o = 32; o > 0; o >>= 1) q += __shfl_xor(q, o);
    __syncthreads();
    if ((c & 63) == 0) red[c >> 6] = q;
    __syncthreads();
    if (c == 0) { float m = 0.f; for (int i = 0; i < 8; ++i) m += red[i]; stat[1] = rsqrtf(m / 512.f + LN_EPS); }
    __syncthreads();
    const float y = dv * stat[1] * lg[c] + lb[c];
    YAB[(size_t)row * 1024 + c] = f2bf(siluf_(y));
}

__global__ void __launch_bounds__(128) k_gla(const bf16_t* __restrict__ UB, const float* __restrict__ GL, const float* __restrict__ ng, bf16_t* __restrict__ YAB) {
    const int b = blockIdx.x >> 2, h = blockIdx.x & 3, v = threadIdx.x;
    constexpr int CH = 16;
    __shared__ float qs[CH][64], ks[CH][64], as[CH][64], os[CH][128], rs[CH];
    float S[64];
#pragma unroll
    for (int k = 0; k < 64; ++k) S[k] = 0.f;
    const float g = ng[h * 128 + v];
    for (int t0 = 0; t0 < SEQ; t0 += CH) {
        __syncthreads();
        for (int i = threadIdx.x; i < CH * 64; i += 128) {
            const int s = i >> 6, k = i & 63; const size_t row = (size_t)b * SEQ + t0 + s;
            qs[s][k] = bf2f(UB[row * 2048 + 512 + h * 64 + k]) * 0.125f;
            ks[s][k] = bf2f(UB[row * 2048 + 768 + h * 64 + k]);
            as[s][k] = expf(GL[row * 256 + h * 64 + k]);
        }
        __syncthreads();
        for (int s = 0; s < CH; ++s) {
            const size_t row = (size_t)b * SEQ + t0 + s;
            const float vv = bf2f(UB[row * 2048 + 1024 + h * 128 + v]);
            float o = 0.f;
#pragma unroll
            for (int k = 0; k < 64; ++k) { S[k] = as[s][k] * S[k] + ks[s][k] * vv; o += qs[s][k] * S[k]; }
            os[s][v] = o;
        }
        __syncthreads();
        {
            const int w = threadIdx.x >> 6, lane = threadIdx.x & 63;
            for (int s = w; s < CH; s += 2) {
                float a = os[s][lane], c2 = os[s][lane + 64]; float q = a * a + c2 * c2;
                for (int o = 32; o > 0; o >>= 1) q += __shfl_xor(q, o);
                if (lane == 0) rs[s] = rsqrtf(q / 128.f + RMS_EPS);
            }
        }
        __syncthreads();
        for (int s = 0; s < CH; ++s) {
            const size_t row = (size_t)b * SEQ + t0 + s;
            const float r = bf2f(UB[row * 2048 + 1536 + h * 128 + v]);
            YAB[row * 1024 + 512 + h * 128 + v] = f2bf(os[s][v] * rs[s] * g * siluf_(r));
        }
    }
}

__global__ void __launch_bounds__(256) k_ln(const float* xin, const float* __restrict__ MIX, const float* __restrict__ modg  , int g_off,
                                            const float* __restrict__ gamma, const float* __restrict__ beta, float* XR,
                                            const float* __restrict__ modn  , int sh_off, int sc_off, bf16_t* __restrict__ hb) {
    const int row = blockIdx.x, b = row / SEQ, tid = threadIdx.x;
    float v[4]; float s = 0.f;
#pragma unroll
    for (int i = 0; i < 4; ++i) { const int c = tid + 256 * i; v[i] = ALPHA * xin[(size_t)row * 1024 + c] + (1.f + modg[(size_t)b * 6144 + g_off + c]) * MIX[(size_t)row * 1024 + c]; s += v[i]; }
    __shared__ float red[4]; __shared__ float stat[2];
    for (int o = 32; o > 0; o >>= 1) s += __shfl_xor(s, o);
    if ((tid & 63) == 0) red[tid >> 6] = s;
    __syncthreads();
    if (tid == 0) stat[0] = (red[0] + red[1] + red[2] + red[3]) / 1024.f;
    __syncthreads();
    const float mean = stat[0]; float q = 0.f;
#pragma unroll
    for (int i = 0; i < 4; ++i) { v[i] -= mean; q += v[i] * v[i]; }
    for (int o = 32; o > 0; o >>= 1) q += __shfl_xor(q, o);
    __syncthreads();
    if ((tid & 63) == 0) red[tid >> 6] = q;
    __syncthreads();
    if (tid == 0) stat[1] = rsqrtf((red[0] + red[1] + red[2] + red[3]) / 1024.f + LN_EPS);
    __syncthreads();
    const float rstd = stat[1];
#pragma unroll
    for (int i = 0; i < 4; ++i) {
        const int c = tid + 256 * i;
        const float y = v[i] * rstd * gamma[c] + beta[c];
        XR[(size_t)row * 1024 + c] = y;
        if (hb) hb[(size_t)row * 1024 + c] = f2bf(y * (1.f + modn[(size_t)b * 6144 + sc_off + c]) + modn[(size_t)b * 6144 + sh_off + c]);
    }
}

__global__ void __launch_bounds__(256) k_router(const bf16_t* __restrict__ HB, const float* __restrict__ wg, const float* __restrict__ bg,
                                                const float* __restrict__ wr, const float* __restrict__ br, int* __restrict__ topi, float* __restrict__ topw) {
    const int tok = blockIdx.x * 4 + (threadIdx.x >> 6), lane = threadIdx.x & 63;
    float acc[36];
#pragma unroll
    for (int i = 0; i < 36; ++i) acc[i] = 0.f;
    for (int i = 0; i < 16; ++i) {
        const int k = lane + 64 * i; const float hv = bf2f(HB[(size_t)tok * 1024 + k]);
#pragma unroll
        for (int g = 0; g < 4; ++g) acc[g] += hv * wg[k * 4 + g];
#pragma unroll
        for (int e = 0; e < 32; ++e) acc[4 + e] += hv * wr[k * 32 + e];
    }
#pragma unroll
    for (int i = 0; i < 36; ++i) { float s = acc[i]; for (int o = 32; o > 0; o >>= 1) s += __shfl_xor(s, o); acc[i] = s; }
    if (lane == 0) {
        float gl[4]; int gi = 0; float gm = -INFINITY;
#pragma unroll
        for (int g = 0; g < 4; ++g) { gl[g] = acc[g] + bg[g]; if (gl[g] > gm) { gm = gl[g]; gi = g; } }
        float den = 0.f;
#pragma unroll
        for (int g = 0; g < 4; ++g) den += expf(gl[g] - gm);
        const float gw_ = 1.f / den;
        float el[8];
#pragma unroll
        for (int g = 0; g < 4; ++g) if (g == gi) {
#pragma unroll
            for (int e = 0; e < 8; ++e) el[e] = acc[4 + g * 8 + e] + br[g * 8 + e];
        }
        int i0 = 0; float v0 = -INFINITY;
#pragma unroll
        for (int e = 0; e < 8; ++e) if (el[e] > v0) { v0 = el[e]; i0 = e; }
        int i1 = 0; float v1 = -INFINITY;
#pragma unroll
        for (int e = 0; e < 8; ++e) if (e != i0 && el[e] > v1) { v1 = el[e]; i1 = e; }
        const float e1 = expf(v1 - v0); const float p0 = 1.f / (1.f + e1), p1 = e1 / (1.f + e1);
        topi[tok * 2 + 0] = gi * 8 + i0; topi[tok * 2 + 1] = gi * 8 + i1;
        topw[tok * 2 + 0] = p0 * gw_; topw[tok * 2 + 1] = p1 * gw_;
    }
}

__global__ void __launch_bounds__(256) k_moe(const bf16_t* __restrict__ HB, const int* __restrict__ topi, const float* __restrict__ topw,
                                             const float* __restrict__ Wg, const float* __restrict__ Wu, const float* __restrict__ Wd, float* __restrict__ Y) {
    const int tok = blockIdx.x, j = threadIdx.x;
    __shared__ float hs[1024]; __shared__ float hid[256];
    for (int i = j; i < 1024; i += 256) hs[i] = bf2f(HB[(size_t)tok * 1024 + i]);
    float y[4] = {0.f, 0.f, 0.f, 0.f};
    for (int slot = 0; slot < 2; ++slot) {
        const int e = topi[tok * 2 + slot]; const float w = topw[tok * 2 + slot];
        __syncthreads();
        const float* wg = Wg + (size_t)e * 1024 * 256; const float* wu = Wu + (size_t)e * 1024 * 256;
        float g = 0.f, u = 0.f;
        for (int k = 0; k < 1024; ++k) { const float hv = hs[k]; g += hv * wg[(size_t)k * 256 + j]; u += hv * wu[(size_t)k * 256 + j]; }
        hid[j] = bf2f(f2bf(siluf_(g) * u * w));
        __syncthreads();
        const float* wd = Wd + (size_t)e * 256 * 1024;
        for (int i = 0; i < 256; ++i) { const float hv = hid[i];
#pragma unroll
            for (int q = 0; q < 4; ++q) y[q] += hv * wd[(size_t)i * 1024 + j + 256 * q]; }
    }
#pragma unroll
    for (int q = 0; q < 4; ++q) Y[(size_t)tok * 1024 + j + 256 * q] = y[q];
}

__global__ void __launch_bounds__(256) k_mla_split(const float* __restrict__ U1, const float* __restrict__ cs, const float* __restrict__ sn,
                                                   bf16_t* __restrict__ CQ, bf16_t* __restrict__ CKV, bf16_t* __restrict__ KR, float* __restrict__ rstd_q, float* __restrict__ rstd_kv) {
    const int row = blockIdx.x * 4 + (threadIdx.x >> 6), lane = threadIdx.x & 63;
    const float* u = U1 + (size_t)row * 704;
    float sq = 0.f, skv = 0.f;
    for (int i = lane; i < 384; i += 64) { const float v = u[i]; sq += v * v; CQ[(size_t)row * 384 + i] = f2bf(v); }
    for (int i = lane; i < 256; i += 64) { const float v = u[384 + i]; skv += v * v; CKV[(size_t)row * 256 + i] = f2bf(v); }
    for (int o = 32; o > 0; o >>= 1) { sq += __shfl_xor(sq, o); skv += __shfl_xor(skv, o); }
    if (lane == 0) { rstd_q[row] = rsqrtf(sq / 384.f + RMS_EPS); rstd_kv[row] = rsqrtf(skv / 256.f + RMS_EPS); }
    if (lane < 32) {
        const float x1 = u[640 + lane], x2 = u[672 + lane], c = cs[(size_t)row * 32 + lane], s = sn[(size_t)row * 32 + lane];
        KR[(size_t)row * 64 + 2 * lane] = f2bf(x1 * c - x2 * s);
        KR[(size_t)row * 64 + 2 * lane + 1] = f2bf(x1 * s + x2 * c);
    }
}

__global__ void __launch_bounds__(256) k_attn(const bf16_t* __restrict__ QF, const bf16_t* __restrict__ KN, const bf16_t* __restrict__ KR,
                                              const bf16_t* __restrict__ VF, bf16_t* __restrict__ OB) {
    const int qb = blockIdx.x, h = blockIdx.y, b = blockIdx.z, tid = threadIdx.x;
    const int r = tid >> 4, c = tid & 15;
    __shared__ float Qs[16][192];
    __shared__ bf16_t Ks[64][194];
    __shared__ bf16_t Vs[64][128];
    __shared__ float Ps[16][64];
    const size_t rowbase = (size_t)b * SEQ;
    const int q0 = qb * 16;
    for (int i = tid; i < 16 * 192; i += 256) { const int rr = i / 192, d = i % 192; Qs[rr][d] = bf2f(QF[(rowbase + q0 + rr) * 1536 + h * 192 + d]); }
    float m = -1e30f, l = 0.f; float o[8];
#pragma unroll
    for (int i = 0; i < 8; ++i) o[i] = 0.f;
    const int qpos = q0 + r;
    const int ntiles = (q0 + 15) / 64 + 1;
    for (int kt = 0; kt < ntiles; ++kt) {
        __syncthreads();
        for (int i = tid; i < 64 * 192; i += 256) { const int kk = i / 192, d = i % 192; const size_t krow = rowbase + kt * 64 + kk;
            Ks[kk][d] = d < 128 ? KN[krow * 1024 + h * 128 + d] : KR[krow * 64 + (d - 128)]; }
        for (int i = tid; i < 64 * 128; i += 256) { const int kk = i >> 7, d = i & 127; Vs[kk][d] = VF[(rowbase + kt * 64 + kk) * 1024 + h * 128 + d]; }
        __syncthreads();
        float s[4] = {0.f, 0.f, 0.f, 0.f};
        for (int d = 0; d < 192; ++d) { const float q = Qs[r][d];
#pragma unroll
            for (int i = 0; i < 4; ++i) s[i] += q * bf2f(Ks[c + 16 * i][d]); }
        float tmax = -INFINITY;
#pragma unroll
        for (int i = 0; i < 4; ++i) { const int key = kt * 64 + c + 16 * i; if (key > qpos) s[i] = -INFINITY; tmax = fmaxf(tmax, s[i]); }
        for (int of = 8; of > 0; of >>= 1) tmax = fmaxf(tmax, __shfl_xor(tmax, of));
        const float mn = fmaxf(m, tmax); const float alpha = exp2f(m - mn);
        float ps = 0.f;
#pragma unroll
        for (int i = 0; i < 4; ++i) { const float p = exp2f(s[i] - mn); ps += p; Ps[r][c + 16 * i] = p; }
        for (int of = 8; of > 0; of >>= 1) ps += __shfl_xor(ps, of);
        l = l * alpha + ps; m = mn;
#pragma unroll
        for (int i = 0; i < 8; ++i) o[i] *= alpha;
        __syncthreads();
        for (int kk = 0; kk < 64; ++kk) { const float p = Ps[r][kk];
#pragma unroll
            for (int i = 0; i < 8; ++i) o[i] += p * bf2f(Vs[kk][c * 8 + i]); }
    }
    const float inv = 1.f / l;
#pragma unroll
    for (int i = 0; i < 8; ++i) OB[(rowbase + q0 + r) * 1024 + h * 128 + c * 8 + i] = f2bf(o[i] * inv);
}

extern "C" void kernel_launch(void* const* d_in, const int* in_sizes, int n_in, void* d_out, int out_size, void* d_ws, size_t ws_size, hipStream_t stream) {
    (void)in_sizes; (void)n_in; (void)out_size; (void)ws_size;
    const float* x = (const float*)d_in[0]; const float* c = (const float*)d_in[1]; const int* pos = (const int*)d_in[2];
    const float* ada_w = (const float*)d_in[3]; const float* ada_b = (const float*)d_in[4];
    const float* ln_mix_g = (const float*)d_in[5]; const float* ln_mix_b = (const float*)d_in[6];
    const float* ln_ffn_g = (const float*)d_in[7]; const float* ln_ffn_b = (const float*)d_in[8];
    const float* ab_w_in = (const float*)d_in[9]; const float* conv_w = (const float*)d_in[10]; const float* conv_b = (const float*)d_in[11];
    const float* conv_ln_g = (const float*)d_in[12]; const float* conv_ln_b = (const float*)d_in[13];
    const float* gate_w = (const float*)d_in[14]; const float* gate_b = (const float*)d_in[15]; const float* gla_norm_g = (const float*)d_in[16];
    const float* ab_w_out = (const float*)d_in[17]; const float* mla_w_in = (const float*)d_in[18];
    const float* q_norm_g = (const float*)d_in[19]; const float* kv_norm_g = (const float*)d_in[20];
    const float* w_uq = (const float*)d_in[21]; const float* w_ukv = (const float*)d_in[22]; const float* mla_w_out = (const float*)d_in[23];
    const float* w_group = (const float*)d_in[24]; const float* b_group = (const float*)d_in[25];
    const float* w_router = (const float*)d_in[26]; const float* b_router = (const float*)d_in[27];
    const float* w_gate = (const float*)d_in[28]; const float* w_up = (const float*)d_in[29]; const float* w_down = (const float*)d_in[30];
    unsigned char* ws = (unsigned char*)d_ws;
    float* XR = (float*)d_out;
    float* MOD = (float*)(ws + WS_MOD); float* CS = (float*)(ws + WS_CS); float* SN = CS + (size_t)T * 32;
    float* RQ = (float*)(ws + WS_RSTD); float* RKV = RQ + T;
    int* TOPI = (int*)(ws + WS_TOPI); float* TOPW = (float*)(ws + WS_TOPW); float* GLOW = (float*)(ws + WS_GLOW);
    bf16_t* HB = (bf16_t*)(ws + WS_HB); bf16_t* UB = (bf16_t*)(ws + WS_UB); float* GL = (float*)(ws + WS_GL); bf16_t* YAB = (bf16_t*)(ws + WS_YAB);
    float* MIX = (float*)(ws + WS_MIX); float* U1 = (float*)(ws + WS_U1);
    bf16_t* QF = (bf16_t*)(ws + WS_QF); bf16_t* KN = (bf16_t*)(ws + WS_KN); bf16_t* KR = (bf16_t*)(ws + WS_KR); bf16_t* VF = (bf16_t*)(ws + WS_VF);
    bf16_t* CQ = (bf16_t*)(ws + WS_CQ); bf16_t* CKV = (bf16_t*)(ws + WS_CKV); bf16_t* OB = (bf16_t*)(ws + WS_OB);

    k_adaln<<<2 * 6144 / 256, 256, 0, stream>>>(c, ada_w, ada_b, MOD);
    k_rope_tab<<<T * 32 / 256, 256, 0, stream>>>(pos, CS, SN);
    const float* mod0 = MOD; const float* mod1 = MOD + 16 * 6144;
    k_modulate<<<T * 1024 / 256, 256, 0, stream>>>(x, mod0, 0, 1024, HB);
    { FInProj f{ab_w_in, AB_IN, 2064, UB, GLOW}; k_gemm<FInProj><<<dim3((2064 + 255) / 256, T / 16), 256, 0, stream>>>(HB, 1024, nullptr, 1024, f); }
    k_gate<<<T, 256, 0, stream>>>(GLOW, gate_w, gate_b, GL);
    k_conv<<<T, 512, 0, stream>>>(UB, conv_w, conv_b, conv_ln_g, conv_ln_b, YAB);
    k_gla<<<64, 128, 0, stream>>>(UB, GL, gla_norm_g, YAB);
    { FPlain f{ab_w_out, 1024, 1024, MIX, 1024, 0}; k_gemm<FPlain><<<dim3(4, T / 16), 256, 0, stream>>>(YAB, 1024, nullptr, 1024, f); }
    k_ln<<<T, 256, 0, stream>>>(x, MIX, mod0, 2048, ln_mix_g, ln_mix_b, XR, mod0, 3072, 4096, HB);
    k_router<<<T / 4, 256, 0, stream>>>(HB, w_group, b_group, w_router, b_router, TOPI, TOPW);
    k_moe<<<T, 256, 0, stream>>>(HB, TOPI, TOPW, w_gate, w_up, w_down, MIX);
    k_ln<<<T, 256, 0, stream>>>(XR, MIX, mod0, 5120, ln_ffn_g, ln_ffn_b, XR, mod1, 0, 1024, HB);
    { FPlain f{mla_w_in, 704, 704, U1, 704, 0}; k_gemm<FPlain><<<dim3(3, T / 16), 256, 0, stream>>>(HB, 1024, nullptr, 1024, f); }
    k_mla_split<<<T / 4, 256, 0, stream>>>(U1, CS, SN, CQ, CKV, KR, RQ, RKV);
    { FQ f{w_uq, 1536, 1280, QF, RQ, CS, SN}; k_gemm<FQ><<<dim3(5, T / 16), 256, 0, stream>>>(CQ, 384, q_norm_g, 384, f); }
    { FKV f{w_ukv, 2048, 2048, KN, VF, RKV}; k_gemm<FKV><<<dim3(8, T / 16), 256, 0, stream>>>(CKV, 256, kv_norm_g, 256, f); }
    k_attn<<<dim3(SEQ / 16, 8, 16), 256, 0, stream>>>(QF, KN, KR, VF, OB);
    { FPlain f{mla_w_out, 1024, 1024, MIX, 1024, 0}; k_gemm<FPlain><<<dim3(4, T / 16), 256, 0, stream>>>(OB, 1024, nullptr, 1024, f); }
    k_ln<<<T, 256, 0, stream>>>(XR, MIX, mod1, 2048, ln_mix_g + 1024, ln_mix_b + 1024, XR, mod1, 3072, 4096, HB);
    k_router<<<T / 4, 256, 0, stream>>>(HB, w_group + 1024 * 4, b_group + 4, w_router + 1024 * 32, b_router + 32, TOPI, TOPW);
    k_moe<<<T, 256, 0, stream>>>(HB, TOPI, TOPW, w_gate + (size_t)32 * 1024 * 256, w_up + (size_t)32 * 1024 * 256, w_down + (size_t)32 * 256 * 1024, MIX);
    k_ln<<<T, 256, 0, stream>>>(XR, MIX, mod1, 5120, ln_ffn_g + 1024, ln_ffn_b + 1024, XR, nullptr, 0, 0, nullptr);
}
```
